# Optimizing an MI355X kernel written in HIP

```python
import math
import jax, jax.numpy as jnp
from jax import lax
import numpy as np

D_MODEL = 1024
BATCH = 16
SEQ = 2048
DEPTH = 1

D_RNN = 1024
N_RNN_BLOCKS = 8
RNN_BLOCK = D_RNN // N_RNN_BLOCKS
CONV_WIDTH = 4
LRU_C = 8.0
HEAD_DIM = 64
N_Q_HEADS = 16
N_KV_HEADS = 4
Q_PER_KV = N_Q_HEADS // N_KV_HEADS
D_ATTN = N_Q_HEADS * HEAD_DIM
D_KV = N_KV_HEADS * HEAD_DIM
WINDOW = 128
BLOCK = 128
ROPE_DIM = HEAD_DIM // 4
ROPE_THETA = 500000.0
NORM_EPS = 1e-6

OFF_RNN_X = 0
OFF_RNN_G = OFF_RNN_X + D_RNN
OFF_Q = OFF_RNN_G + D_RNN
OFF_K = OFF_Q + D_ATTN
OFF_V = OFF_K + D_KV
OFF_ATTN_G = OFF_V + D_KV
OFF_MERGE_R = OFF_ATTN_G + D_ATTN
OFF_MERGE_A = OFF_MERGE_R + D_MODEL
D_IN = OFF_MERGE_A + D_MODEL

kernel_name = "hybrid_rglru_swa_sink_gated_merge"


def rms_norm(x, g):
    xf = x.astype(jnp.float32)
    y = xf * lax.rsqrt(jnp.mean(xf * xf, axis=-1, keepdims=True) + NORM_EPS)
    return (y * g.astype(jnp.float32)).astype(x.dtype)


def causal_depthwise_conv(u, w, b):
    C = u.shape[-1]
    y = lax.conv_general_dilated(
        u, w.astype(u.dtype)[:, None, :], window_strides=(1,),
        padding=[(CONV_WIDTH - 1, 0)], dimension_numbers=("NWC", "WIO", "NWC"),
        feature_group_count=C)
    return y + b.astype(u.dtype)


def block_diag_linear(u, w, b):
    B, S, _ = u.shape
    ub = u.reshape(B, S, N_RNN_BLOCKS, RNN_BLOCK)
    y = jnp.einsum("bsnc,ncd->bsnd", ub, w.astype(u.dtype))
    return y.reshape(B, S, D_RNN) + b.astype(u.dtype)


def rg_lru(u, w_a, b_a, w_x, b_x, lam):
    r = jax.nn.sigmoid(block_diag_linear(u, w_a, b_a).astype(jnp.float32))
    i = jax.nn.sigmoid(block_diag_linear(u, w_x, b_x).astype(jnp.float32))
    log_a = -LRU_C * r * jax.nn.softplus(-lam.astype(jnp.float32))
    a = jnp.exp(log_a)
    b = jnp.sqrt(-jnp.expm1(2.0 * log_a)) * (i * u.astype(jnp.float32))

    def combine(c1, c2):
        a1, b1 = c1
        a2, b2 = c2
        return a1 * a2, a2 * b1 + b2

    _, h = lax.associative_scan(combine, (a, b), axis=1)
    return h.astype(u.dtype)


def rope_tables(seq_len):
    pos = jnp.arange(seq_len, dtype=jnp.float32)
    inv_freq = ROPE_THETA ** (-jnp.arange(0, ROPE_DIM, 2, dtype=jnp.float32) / ROPE_DIM)
    ang = pos[:, None] * inv_freq[None, :]
    return jnp.cos(ang)[:, None, :], jnp.sin(ang)[:, None, :]


def apply_partial_rope(t, cos, sin):
    half = ROPE_DIM // 2
    c = cos.astype(t.dtype)
    s = sin.astype(t.dtype)
    t1 = t[..., :half]
    t2 = t[..., half:ROPE_DIM]
    rot = jnp.concatenate([t1 * c - t2 * s, t2 * c + t1 * s], axis=-1)
    return jnp.concatenate([rot, t[..., ROPE_DIM:]], axis=-1)


def sliding_window_attention_with_sinks(q, k, v, sinks):
    B, S, _, _ = q.shape
    nb = S // BLOCK
    qb = q.reshape(B, nb, BLOCK, N_KV_HEADS, Q_PER_KV, HEAD_DIM)
    kb = k.reshape(B, nb, BLOCK, N_KV_HEADS, HEAD_DIM)
    vb = v.reshape(B, nb, BLOCK, N_KV_HEADS, HEAD_DIM)
    zeros = jnp.zeros_like(kb[:, :1])
    kw = jnp.concatenate([jnp.concatenate([zeros, kb[:, :-1]], axis=1), kb], axis=2)
    vw = jnp.concatenate([jnp.concatenate([zeros, vb[:, :-1]], axis=1), vb], axis=2)

    scale = 1.0 / math.sqrt(HEAD_DIM)
    scores = jnp.einsum("bnqkgd,bnjkd->bnkgqj", qb, kw).astype(jnp.float32) * scale

    blk = jnp.arange(nb)[:, None, None]
    q_abs = blk * BLOCK + jnp.arange(BLOCK)[None, :, None]
    k_abs = (blk - 1) * BLOCK + jnp.arange(2 * BLOCK)[None, None, :]
    valid = (k_abs <= q_abs) & (q_abs - k_abs < WINDOW) & (k_abs >= 0)
    scores = jnp.where(valid[None, :, None, None, :, :], scores, -jnp.inf)

    sink = sinks.astype(jnp.float32).reshape(N_KV_HEADS, Q_PER_KV)[None, None, :, :, None]
    m = jnp.maximum(jnp.max(scores, axis=-1), sink)
    p = jnp.exp(scores - m[..., None])
    denom = jnp.sum(p, axis=-1) + jnp.exp(sink - m)
    probs = (p / denom[..., None]).astype(v.dtype)
    out = jnp.einsum("bnkgqj,bnjkd->bnqkgd", probs, vw)
    return out.reshape(B, S, D_ATTN)


def setup_inputs(seed: int = 0) -> dict:
    key = jax.random.key(seed)
    ks = jax.random.split(key, 17)
    f32 = jnp.float32
    x = jax.random.normal(ks[0], (BATCH, SEQ, D_MODEL), f32)
    norm_g = 1.0 + 0.02 * jax.random.normal(ks[1], (DEPTH, D_MODEL), f32)
    w_in = jax.random.normal(ks[2], (DEPTH, D_MODEL, D_IN), f32) * D_MODEL ** -0.5
    conv_w = jax.random.normal(ks[3], (DEPTH, CONV_WIDTH, D_RNN), f32) * CONV_WIDTH ** -0.5
    conv_b = 0.02 * jax.random.normal(ks[4], (DEPTH, D_RNN), f32)
    lru_w_a = jax.random.normal(ks[5], (DEPTH, N_RNN_BLOCKS, RNN_BLOCK, RNN_BLOCK), f32) * RNN_BLOCK ** -0.5
    lru_b_a = 0.02 * jax.random.normal(ks[6], (DEPTH, D_RNN), f32)
    lru_w_x = jax.random.normal(ks[7], (DEPTH, N_RNN_BLOCKS, RNN_BLOCK, RNN_BLOCK), f32) * RNN_BLOCK ** -0.5
    lru_b_x = 0.02 * jax.random.normal(ks[8], (DEPTH, D_RNN), f32)
    a0 = jax.random.uniform(ks[9], (DEPTH, D_RNN), f32, 0.9, 0.999)
    lru_lambda = jnp.log(a0) - jnp.log1p(-a0)
    attn_sinks = 0.5 * jax.random.normal(ks[10], (DEPTH, N_Q_HEADS), f32)
    w_rnn_out = jax.random.normal(ks[11], (DEPTH, D_RNN, D_MODEL), f32) * D_RNN ** -0.5
    w_attn_out = jax.random.normal(ks[12], (DEPTH, D_ATTN, D_MODEL), f32) * D_ATTN ** -0.5
    w_o = jax.random.normal(ks[13], (DEPTH, D_MODEL, D_MODEL), f32) * D_MODEL ** -0.5
    final_norm_g = 1.0 + 0.02 * jax.random.normal(ks[14], (D_MODEL,), f32)
    return {"x": x, "norm_g": norm_g, "w_in": w_in, "conv_w": conv_w, "conv_b": conv_b,
            "lru_w_a": lru_w_a, "lru_b_a": lru_b_a, "lru_w_x": lru_w_x, "lru_b_x": lru_b_x,
            "lru_lambda": lru_lambda, "attn_sinks": attn_sinks, "w_rnn_out": w_rnn_out,
            "w_attn_out": w_attn_out, "w_o": w_o, "final_norm_g": final_norm_g}


def reference(x, norm_g, w_in, conv_w, conv_b, lru_w_a, lru_b_a, lru_w_x, lru_b_x,
              lru_lambda, attn_sinks, w_rnn_out, w_attn_out, w_o, final_norm_g):
    B, S, _ = x.shape
    cos, sin = rope_tables(S)
    for l in range(DEPTH):
        h = rms_norm(x, norm_g[l])
        proj = jnp.einsum("bsd,de->bse", h, w_in[l])
        u = proj[..., OFF_RNN_X:OFF_RNN_G]
        g_rnn = proj[..., OFF_RNN_G:OFF_Q]
        q = proj[..., OFF_Q:OFF_K].reshape(B, S, N_Q_HEADS, HEAD_DIM)
        k = proj[..., OFF_K:OFF_V].reshape(B, S, N_KV_HEADS, HEAD_DIM)
        v = proj[..., OFF_V:OFF_ATTN_G].reshape(B, S, N_KV_HEADS, HEAD_DIM)
        g_attn = proj[..., OFF_ATTN_G:OFF_MERGE_R]
        m_rnn = proj[..., OFF_MERGE_R:OFF_MERGE_A]
        m_attn = proj[..., OFF_MERGE_A:D_IN]

        u = causal_depthwise_conv(u, conv_w[l], conv_b[l])
        y_rnn = rg_lru(u, lru_w_a[l], lru_b_a[l], lru_w_x[l], lru_b_x[l], lru_lambda[l]) * jax.nn.silu(g_rnn)

        q = apply_partial_rope(q, cos, sin)
        k = apply_partial_rope(k, cos, sin)
        y_attn = sliding_window_attention_with_sinks(q, k, v, attn_sinks[l]) * jax.nn.silu(g_attn)

        merged = (jax.nn.sigmoid(m_rnn) * jnp.einsum("bsr,rd->bsd", y_rnn, w_rnn_out[l])
                  + jax.nn.sigmoid(m_attn) * jnp.einsum("bsa,ad->bsd", y_attn, w_attn_out[l]))
        x = x + jnp.einsum("bsd,de->bse", merged, w_o[l])
    return rms_norm(x, final_norm_g)
```

```cpp
#include <hip/hip_runtime.h>
#include <hip/hip_cooperative_groups.h>
#include <cstdio>
#include <cstdint>
namespace cg = cooperative_groups;

#ifndef DBG_ATT
#define DBG_ATT 0
#endif
#ifndef MK_N_LAUNCHES
#define MK_N_LAUNCHES 1
#endif

#define LAS __attribute__((address_space(3)))
typedef _Float16 h16;
typedef _Float16 h16x8 __attribute__((ext_vector_type(8)));
typedef _Float16 h16x4 __attribute__((ext_vector_type(4)));
typedef _Float16 h16x2 __attribute__((ext_vector_type(2)));
typedef float f32x4 __attribute__((ext_vector_type(4)));
typedef unsigned u32x4 __attribute__((ext_vector_type(4)));
typedef unsigned u32x2 __attribute__((ext_vector_type(2)));

constexpr int BATCH = 16, SEQ = 2048, DM = 1024, MTOK = BATCH * SEQ;
constexpr int NIN = 6656;
constexpr int OFF_G = 1024, OFF_Q = 2048, OFF_K = 3072, OFF_V = 3328, OFF_AG = 3584, OFF_MR = 4608, OFF_MA = 5632;
constexpr float NORM_EPS = 1e-6f;
constexpr float LOG2E = 1.4426950408889634f;
constexpr float QSCALE = 0.125f * LOG2E;
constexpr int N_RNN_UNITS = 128, N_ATT_UNITS = 1024;

constexpr size_t MiB = 1u << 20;
constexpr size_t WS_CTL = 0, CTL_ZERO_BYTES = 4096;
constexpr size_t WS_ROPE = 1 * MiB;
constexpr size_t WS_WIN = 2 * MiB;
constexpr size_t WS_WCAT = 15 * MiB;
constexpr size_t WS_WO = 19 * MiB;
constexpr size_t WS_WG = 21 * MiB;
constexpr size_t WS_RSS = 22 * MiB;
constexpr size_t WS_XN = 32 * MiB;
constexpr size_t WS_U = 96 * MiB, WS_SGR = 160 * MiB, WS_Q = 224 * MiB, WS_K = 288 * MiB, WS_V = 304 * MiB, WS_SGA = 320 * MiB, WS_SR = 384 * MiB, WS_SA = 448 * MiB;
constexpr size_t WS_END = 512 * MiB;

namespace pg8 {
constexpr int BM = 256, BK = 64, HALF = 128, HTB = HALF * BK * 2, STAGE_BYTES = 8 * HTB, NXCD = 8, WGM = 8;
__host__ __device__ __forceinline__ int lds_byte(int r, int c) { const int st = (r >> 4) * 2 + (c >> 5), rr = r & 15, cc = c & 31, ob = rr * 64 + cc * 2; return st * 1024 + (ob ^ (((ob >> 9) & 1) << 5)); }
__host__ __device__ __forceinline__ void stage_rc(int b, int& R, int& C) { const int st = b / 1024, sb = b % 1024, swz = sb ^ (((sb >> 9) & 1) << 5); R = (st >> 1) * 16 + swz / 64; C = (st & 1) * 32 + (swz % 64) / 2; }
__host__ __device__ __forceinline__ int perm32(int rho) { const int n = rho >> 4, i = rho & 15; return 8 * (i >> 2) + 4 * n + (i & 3); }

struct Unit { int pm, pn; };
struct Gemm { const h16* A; const h16* Bt; int M, N, K; };

struct StaticOrder {
    int nM, nN, nwg, G, c;
    __host__ __device__ void init(int M, int N, int G_, int c_) { nM = M / BM; nN = N / BM; nwg = nM * nN; G = G_; c = c_; }
    __host__ __device__ bool next(int i, Unit& u) const {
        const long L = (long)i * G + c; if (L >= nwg) return false;
        int wgid = (int)L; { const int q = nwg / NXCD, r = nwg % NXCD, xcd = wgid % NXCD, off = wgid / NXCD; wgid = (xcd < r ? xcd * (q + 1) : r * (q + 1) + (xcd - r) * q) + off; }
        const int nig = WGM * nN, gid = wgid / nig, fm = gid * WGM, gsz = (nM - fm) < WGM ? (nM - fm) : WGM;
        u.pm = fm + ((wgid % nig) % gsz); u.pn = (wgid % nig) / gsz; return true;
    }
};

template <class Epi>
__device__ __forceinline__ void gemm_phase(LAS unsigned char* lds, const Gemm g, const StaticOrder& S, const Epi& E) {
    const int tid = threadIdx.x, wid = __builtin_amdgcn_readfirstlane(tid >> 6), lane = tid & 63, wr = wid >> 2, wc = wid & 3, fr = lane & 15, fq = lane >> 4;
    const int K = g.K, nt = K / BK;
    unsigned voffA[2], voffB[2];
#pragma unroll
    for (int i = 0; i < 2; ++i) { int R, C; stage_rc(tid * 16 + i * 8192, R, C); const int Rb = Epi::PERM ? ((R & ~31) + perm32(R & 31)) : R;
        voffA[i] = (unsigned)(R * K + C) * 2u; voffB[i] = (unsigned)(Rb * K + C) * 2u; }
    const size_t kstep = (size_t)(BK * 2);
    const size_t hstep = (size_t)HALF * K * 2;
    const size_t tstep = 2 * hstep;
    const unsigned ldsw = (unsigned)wid * 1024u;
    const int aoff = lds_byte(wr * 64 + fr, fq * 8), boff = lds_byte(wc * 32 + fr, fq * 8);
#define PG8_SA(b, h) (((b) * 2 + (h)) * HTB)
#define PG8_SB(b, h) ((4 + (b) * 2 + (h)) * HTB)
#define PG8_STAGE(bufoff, gbase, voff) do { _Pragma("unroll") for (int _i = 0; _i < 2; ++_i) \
        __builtin_amdgcn_global_load_lds((const unsigned*)((const char*)(gbase) + (voff)[_i]), (LAS unsigned*)(lds + (bufoff) + ldsw + _i * 8192), 16, 0, 0); } while (0)
#define PG8_LDA(dst, b, h) do { _Pragma("unroll") for (int m = 0; m < 4; ++m) _Pragma("unroll") for (int k = 0; k < 2; ++k) dst[m][k] = *(const LAS h16x8*)(lds + PG8_SA(b, h) + aoff + m * 2048 + k * 1024); } while (0)
#define PG8_LDB(dst, b, h) do { _Pragma("unroll") for (int n = 0; n < 2; ++n) _Pragma("unroll") for (int k = 0; k < 2; ++k) dst[n][k] = *(const LAS h16x8*)(lds + PG8_SB(b, h) + boff + n * 2048 + k * 1024); } while (0)
#define PG8_MMA(ai, bj, At, Bt) do { __builtin_amdgcn_s_setprio(1); _Pragma("unroll") for (int m = 0; m < 4; ++m) _Pragma("unroll") for (int n = 0; n < 2; ++n) _Pragma("unroll") for (int k = 0; k < 2; ++k) \
        acc[ai][bj][m][n] = __builtin_amdgcn_mfma_f32_16x16x32_f16(Bt[n][k], At[m][k], acc[ai][bj][m][n], 0, 0, 0); __builtin_amdgcn_s_setprio(0); } while (0)
#define PG8_WAIT_V(n) asm volatile("s_waitcnt vmcnt(" #n ")" ::: "memory")
#define PG8_WAIT_L(n) asm volatile("s_waitcnt lgkmcnt(" #n ")" ::: "memory")
#define PG8_BAR __builtin_amdgcn_s_barrier()
#define PG8_SCHED __builtin_amdgcn_sched_barrier(0)
    Unit cur, nxt; int ui = 0;
    if (!S.next(0, cur)) return;
    f32x4 acc[2][2][4][2];
#pragma unroll
    for (int a = 0; a < 2; ++a)
#pragma unroll
        for (int b = 0; b < 2; ++b)
#pragma unroll
            for (int m = 0; m < 4; ++m)
#pragma unroll
                for (int n = 0; n < 2; ++n) acc[a][b][m][n] = (f32x4){0.f, 0.f, 0.f, 0.f};
    h16x8 At[4][2], B0[2][2], B1[2][2];
    const char* cA = (const char*)g.A + (size_t)cur.pm * tstep; const char* cB = (const char*)g.Bt + (size_t)cur.pn * tstep;
    PG8_STAGE(PG8_SB(0, 0), cB, voffB); PG8_STAGE(PG8_SB(0, 1), cB + hstep, voffB); PG8_STAGE(PG8_SA(0, 0), cA, voffA); PG8_STAGE(PG8_SA(0, 1), cA + hstep, voffA);
    if (wr == 1) PG8_BAR;
    PG8_WAIT_V(2); PG8_BAR;
    PG8_STAGE(PG8_SB(1, 0), cB + kstep, voffB); PG8_STAGE(PG8_SA(1, 0), cA + kstep, voffA); PG8_STAGE(PG8_SB(1, 1), cB + hstep + kstep, voffB);
    PG8_WAIT_V(6); PG8_BAR;
    for (;;) {
        const bool has_next = S.next(ui + 1, nxt);
        const char* nA = has_next ? (const char*)g.A + (size_t)nxt.pm * tstep : cA; const char* nB = has_next ? (const char*)g.Bt + (size_t)nxt.pn * tstep : cB;
        for (int t = 0; t < nt; t += 2) {
            if constexpr (Epi::HAS_MID) { if (t == Epi::MID_T) E.mid(acc, cur, wr, wc, fr, fq); }
            const bool last = (t == nt - 2);
            const char* a1 = cA + (size_t)(t + 1) * kstep;
            const char* a2 = last ? nA : cA + (size_t)(t + 2) * kstep; const char* b2 = last ? nB : cB + (size_t)(t + 2) * kstep;
            const char* a3 = a2 + kstep; const char* b3 = b2 + kstep;
            PG8_LDB(B0, 0, 0); PG8_LDB(B1, 0, 1); PG8_SCHED; PG8_LDA(At, 0, 0); PG8_STAGE(PG8_SA(1, 1), a1 + hstep, voffA);
            PG8_WAIT_V(8); PG8_WAIT_L(0); PG8_BAR; PG8_MMA(0, 0, At, B0); PG8_MMA(0, 1, At, B1); PG8_BAR; PG8_SCHED;
            PG8_LDA(At, 0, 1); PG8_STAGE(PG8_SB(0, 0), b2, voffB); PG8_STAGE(PG8_SB(0, 1), b2 + hstep, voffB); PG8_STAGE(PG8_SA(0, 0), a2, voffA);
            PG8_WAIT_V(8); PG8_WAIT_L(0); PG8_BAR; PG8_MMA(1, 0, At, B0); PG8_MMA(1, 1, At, B1); PG8_BAR; PG8_SCHED;
            PG8_LDB(B0, 1, 0); PG8_LDB(B1, 1, 1); PG8_SCHED; PG8_LDA(At, 1, 0); PG8_STAGE(PG8_SA(0, 1), a2 + hstep, voffA);
            PG8_WAIT_V(8); PG8_WAIT_L(0); PG8_BAR; PG8_MMA(0, 0, At, B0); PG8_MMA(0, 1, At, B1); PG8_BAR; PG8_SCHED;
            PG8_LDA(At, 1, 1); PG8_STAGE(PG8_SB(1, 0), b3, voffB); PG8_STAGE(PG8_SB(1, 1), b3 + hstep, voffB); PG8_STAGE(PG8_SA(1, 0), a3, voffA);
            PG8_WAIT_V(8); PG8_WAIT_L(0); PG8_BAR; PG8_MMA(1, 0, At, B0); PG8_MMA(1, 1, At, B1); PG8_BAR; PG8_SCHED;
        }
        if (wr == 0) PG8_BAR;
        E(acc, cur, wr, wc, fr, fq);
        if (!has_next) break;
#pragma unroll
        for (int a = 0; a < 2; ++a)
#pragma unroll
            for (int b = 0; b < 2; ++b)
#pragma unroll
                for (int m = 0; m < 4; ++m)
#pragma unroll
                    for (int n = 0; n < 2; ++n) acc[a][b][m][n] = (f32x4){0.f, 0.f, 0.f, 0.f};
        cur = nxt; cA = nA; cB = nB; ++ui;
        if (wr == 1) PG8_BAR;
    }
    PG8_WAIT_V(0);
    PG8_BAR;
#undef PG8_SA
#undef PG8_SB
#undef PG8_STAGE
#undef PG8_LDA
#undef PG8_LDB
#undef PG8_MMA
#undef PG8_WAIT_V
#undef PG8_WAIT_L
#undef PG8_BAR
#undef PG8_SCHED
}
}

__device__ __forceinline__ unsigned pkh(float a, float b) { h16x2 v = {(h16)a, (h16)b}; return __builtin_bit_cast(unsigned, v); }
__device__ __forceinline__ u32x4 pk8(f32x4 a, f32x4 b) { u32x4 w; w.x = pkh(a[0], a[1]); w.y = pkh(a[2], a[3]); w.z = pkh(b[0], b[1]); w.w = pkh(b[2], b[3]); return w; }
__device__ __forceinline__ float sigm(float x) { return __builtin_amdgcn_rcpf(1.f + __builtin_amdgcn_exp2f(-LOG2E * x)); }
__device__ __forceinline__ f32x4 sigm4(f32x4 v) { f32x4 r; r[0] = sigm(v[0]); r[1] = sigm(v[1]); r[2] = sigm(v[2]); r[3] = sigm(v[3]); return r; }
__device__ __forceinline__ float wave_sum(float v) {
#pragma unroll
    for (int o = 1; o < 64; o <<= 1) v += __shfl_xor(v, o);
    return v;
}

struct EpiProj {
    static constexpr bool PERM = true, HAS_MID = false; static constexpr int MID_T = -1;
    h16 *U, *SGr, *Q, *Kb, *Vb, *SGa, *SR, *SA; const float* rope;
    __device__ __forceinline__ void mid(f32x4 (&)[2][2][4][2], const pg8::Unit&, int, int, int, int) const {}
    __device__ __forceinline__ void operator()(const f32x4 (&acc)[2][2][4][2], const pg8::Unit& u, int wr, int wc, int fr, int fq) const {
        const int pn = u.pn;
        const int rowb = u.pm * 256 + wr * 64 + fr;
        const int cw = wc * 32 + 8 * fq;
        if (pn >= 18) {
            const int col = 128 * (pn - 18) + cw;
#pragma unroll
            for (int ai = 0; ai < 2; ++ai)
#pragma unroll
                for (int m = 0; m < 4; ++m) { const size_t off = (size_t)(rowb + ai * 128 + m * 16) * 1024 + col;
                    const f32x4 r0 = sigm4(acc[ai][0][m][0]), r1 = sigm4(acc[ai][0][m][1]);
                    f32x4 a0 = sigm4(acc[ai][1][m][0]), a1 = sigm4(acc[ai][1][m][1]);
#pragma unroll
                    for (int e = 0; e < 4; ++e) { a0[e] = fmaxf(a0[e], 6.2e-5f); a1[e] = fmaxf(a1[e], 6.2e-5f); }
                    *(u32x4*)(SR + off) = pk8(r0, r1); *(u32x4*)(SA + off) = pk8(a0, a1); }
            return;
        }
        h16* dst; int pitch = 1024, cb, mode; float scale = 1.f;
        if (pn < 4) { dst = U; cb = pn * 256; mode = 0; }
        else if (pn < 8) { dst = SGr; cb = (pn - 4) * 256; mode = 1; }
        else if (pn < 12) { dst = Q; cb = (pn - 8) * 256; mode = 2; scale = QSCALE; }
        else if (pn == 12) { dst = Kb; cb = 0; mode = 2; pitch = 256; }
        else if (pn == 13) { dst = Vb; cb = 0; mode = 0; pitch = 256; }
        else { dst = SGa; cb = (pn - 14) * 256; mode = 1; }
        if (mode == 0) {
#pragma unroll
            for (int ai = 0; ai < 2; ++ai)
#pragma unroll
                for (int m = 0; m < 4; ++m) { h16* rowp = dst + (size_t)(rowb + ai * 128 + m * 16) * pitch + cb + cw;
#pragma unroll
                    for (int bj = 0; bj < 2; ++bj) *(u32x4*)(rowp + bj * 128) = pk8(acc[ai][bj][m][0], acc[ai][bj][m][1]); }
        } else if (mode == 1) {
#pragma unroll
            for (int ai = 0; ai < 2; ++ai)
#pragma unroll
                for (int m = 0; m < 4; ++m) { h16* rowp = dst + (size_t)(rowb + ai * 128 + m * 16) * pitch + cb + cw;
#pragma unroll
                    for (int bj = 0; bj < 2; ++bj) { const f32x4 v0 = acc[ai][bj][m][0], v1 = acc[ai][bj][m][1];
                        *(u32x4*)(rowp + bj * 128) = pk8(v0 * sigm4(v0), v1 * sigm4(v1)); } }
        } else {
            const bool ropewave = (wc & 1) == 0;
            const float sgn = (fq == 0) ? -1.f : 1.f;
#pragma unroll
            for (int ai = 0; ai < 2; ++ai)
#pragma unroll
                for (int m = 0; m < 4; ++m) { const int row = rowb + ai * 128 + m * 16; h16* rowp = dst + (size_t)row * pitch + cb + cw;
                    const float* rp = rope + (size_t)(row & (SEQ - 1)) * 16;
#pragma unroll
                    for (int bj = 0; bj < 2; ++bj) { f32x4 v0 = acc[ai][bj][m][0], v1 = acc[ai][bj][m][1];
                        if (ropewave) {
                            f32x4 p0, p1;
#pragma unroll
                            for (int e = 0; e < 4; ++e) { p0[e] = __shfl_xor(v0[e], 16); p1[e] = __shfl_xor(v1[e], 16); }
                            if (fq < 2) { const f32x4 c0 = *(const f32x4*)(rp), c1 = *(const f32x4*)(rp + 4), s0 = *(const f32x4*)(rp + 8), s1 = *(const f32x4*)(rp + 12);
                                v0 = v0 * c0 + (p0 * s0) * sgn; v1 = v1 * c1 + (p1 * s1) * sgn; }
                        }
                        *(u32x4*)(rowp + bj * 128) = pk8(v0 * scale, v1 * scale); } }
        }
    }
};

struct EpiMerge {
    static constexpr bool PERM = true, HAS_MID = true; static constexpr int MID_T = 16;
    const h16 *SR, *SA; h16* MG;
    __device__ __forceinline__ void mid(f32x4 (&acc)[2][2][4][2], const pg8::Unit& u, int wr, int wc, int fr, int fq) const {
        int rowb = u.pm * 256 + wr * 64 + fr; const int colb = u.pn * 256 + wc * 32 + 8 * fq;
        asm volatile("" : "+v"(rowb));
#pragma unroll
        for (int ai = 0; ai < 2; ++ai)
#pragma unroll
            for (int m = 0; m < 4; ++m)
#pragma unroll
                for (int bj = 0; bj < 2; ++bj) { const size_t off = (size_t)(rowb + ai * 128 + m * 16) * 1024 + colb + bj * 128;
                    const h16x8 sr = *(const h16x8*)(SR + off), sa = *(const h16x8*)(SA + off);
#pragma unroll
                    for (int e = 0; e < 4; ++e) { acc[ai][bj][m][0][e] *= (float)sr[e] * __builtin_amdgcn_rcpf((float)sa[e]);
                        acc[ai][bj][m][1][e] *= (float)sr[4 + e] * __builtin_amdgcn_rcpf((float)sa[4 + e]); }
                    asm volatile("" : "+v"(acc[ai][bj][m][0]), "+v"(acc[ai][bj][m][1]) :: "memory"); }
    }
    __device__ __forceinline__ void operator()(const f32x4 (&acc)[2][2][4][2], const pg8::Unit& u, int wr, int wc, int fr, int fq) const {
        const int rowb = u.pm * 256 + wr * 64 + fr, colb = u.pn * 256 + wc * 32 + 8 * fq;
#pragma unroll
        for (int ai = 0; ai < 2; ++ai)
#pragma unroll
            for (int m = 0; m < 4; ++m)
#pragma unroll
                for (int bj = 0; bj < 2; ++bj) { const size_t off = (size_t)(rowb + ai * 128 + m * 16) * 1024 + colb + bj * 128;
                    const h16x8 sa = *(const h16x8*)(SA + off);
                    f32x4 v0 = acc[ai][bj][m][0], v1 = acc[ai][bj][m][1];
#pragma unroll
                    for (int e = 0; e < 4; ++e) { v0[e] *= (float)sa[e]; v1[e] *= (float)sa[4 + e]; }
                    *(u32x4*)(MG + off) = pk8(v0, v1); asm volatile("" ::: "memory"); }
    }
};

struct EpiOut {
    static constexpr bool PERM = true, HAS_MID = false; static constexpr int MID_T = -1;
    const float* x; float* out; float* rss;
    __device__ __forceinline__ void mid(f32x4 (&)[2][2][4][2], const pg8::Unit&, int, int, int, int) const {}
    __device__ __forceinline__ void operator()(const f32x4 (&acc)[2][2][4][2], const pg8::Unit& u, int wr, int wc, int fr, int fq) const {
        const int rowb = u.pm * 256 + wr * 64 + fr, colb = u.pn * 256 + wc * 32 + 8 * fq;
#pragma unroll
        for (int ai = 0; ai < 2; ++ai)
#pragma unroll
            for (int m = 0; m < 4; ++m) { const int row = rowb + ai * 128 + m * 16; float ss = 0.f;
#pragma unroll
                for (int bj = 0; bj < 2; ++bj) { const size_t off = (size_t)row * 1024 + colb + bj * 128;
                    const f32x4 v0 = *(const f32x4*)(x + off) + acc[ai][bj][m][0], v1 = *(const f32x4*)(x + off + 4) + acc[ai][bj][m][1];
                    *(f32x4*)(out + off) = v0; *(f32x4*)(out + off + 4) = v1;
                    ss += (v0[0] * v0[0] + v0[1] * v0[1]) + (v0[2] * v0[2] + v0[3] * v0[3]) + (v1[0] * v1[0] + v1[1] * v1[1]) + (v1[2] * v1[2] + v1[3] * v1[3]); }
                ss += __shfl_xor(ss, 16); ss += __shfl_xor(ss, 32);
                if (fq == 0) rss[(size_t)row * 16 + u.pn * 4 + wc] = ss; }
    }
};

struct Args {
    const float *x, *norm_g, *w_in, *conv_w, *conv_b, *lru_w_a, *lru_b_a, *lru_w_x, *lru_b_x, *lam, *sinks, *w_rnn_out, *w_attn_out, *w_o, *fng;
    float* out; unsigned char* ws; int ph_lo, ph_hi;
};

__device__ __forceinline__ void transpose_item(const float* W, int ldw, int k0, int ns0, h16* WT, int ldt, int nd0, int kd0, LAS float* scr, int lane) {
#pragma unroll 8
    for (int i = 0; i < 32; ++i) { const int kk = 2 * i + (lane >> 5); scr[kk * 33 + (lane & 31)] = W[(size_t)(k0 + kk) * ldw + ns0 + (lane & 31)]; }
    asm volatile("s_waitcnt lgkmcnt(0)" ::: "memory");
    const int c = lane & 7;
#pragma unroll
    for (int j = 0; j < 4; ++j) { const int n = (lane >> 3) + 8 * j; const LAS float* s = scr + (8 * c) * 33 + n;
        u32x4 o; o.x = pkh(s[0 * 33], s[1 * 33]); o.y = pkh(s[2 * 33], s[3 * 33]); o.z = pkh(s[4 * 33], s[5 * 33]); o.w = pkh(s[6 * 33], s[7 * 33]);
        *(u32x4*)(WT + (size_t)(nd0 + n) * ldt + kd0 + 8 * c) = o; }
    asm volatile("s_waitcnt lgkmcnt(0)" ::: "memory");
}

__device__ __forceinline__ void p0_prologue(const Args& a, LAS unsigned char* lds) {
    const int tid = threadIdx.x, lane = tid & 63, wave = __builtin_amdgcn_readfirstlane(tid >> 6);
    unsigned char* ws = a.ws;
    LAS float* scr = (LAS float*)(lds + wave * 16384);
    const int gw = blockIdx.x * 8 + wave, NGW = gridDim.x * 8;
    constexpr int I_IN = 16 * 208, I_SQ = 16 * 32, I_G = 8 * 8;
    constexpr int NITEMS = I_IN + 3 * I_SQ + 2 * I_G;
    for (int it = gw; it < NITEMS; it += NGW) {
        int r = it;
        if (r < I_IN) { const int kb = r / 208, nb = r % 208, nd0 = nb * 32; int ns0 = nd0;
            if (nd0 >= OFF_MR) { const int i = (nd0 - OFF_MR) >> 8, c = (nd0 - OFF_MR) & 255; ns0 = (c < 128) ? OFF_MR + 128 * i + c : OFF_MA + 128 * i + (c - 128); }
            transpose_item(a.w_in, NIN, kb * 64, ns0, (h16*)(ws + WS_WIN), 1024, nd0, kb * 64, scr, lane); continue; }
        r -= I_IN;
        if (r < I_SQ) { const int kb = r / 32, nb = r % 32; transpose_item(a.w_rnn_out, 1024, kb * 64, nb * 32, (h16*)(ws + WS_WCAT), 2048, nb * 32, kb * 64, scr, lane); continue; }
        r -= I_SQ;
        if (r < I_SQ) { const int kb = r / 32, nb = r % 32; transpose_item(a.w_attn_out, 1024, kb * 64, nb * 32, (h16*)(ws + WS_WCAT), 2048, nb * 32, 1024 + kb * 64, scr, lane); continue; }
        r -= I_SQ;
        if (r < I_SQ) { const int kb = r / 32, nb = r % 32; transpose_item(a.w_o, 1024, kb * 64, nb * 32, (h16*)(ws + WS_WO), 1024, nb * 32, kb * 64, scr, lane); continue; }
        r -= I_SQ;
        { const int which = r / I_G, rr = r % I_G, blk = rr / 8, kb = (rr % 8) / 4, nb = rr % 4;
          const float* W = (which ? a.lru_w_x : a.lru_w_a) + (size_t)blk * 16384;
          transpose_item(W, 128, kb * 64, nb * 32, (h16*)(ws + WS_WG) + (size_t)(which * 8 + blk) * 16384, 128, nb * 32, kb * 64, scr, lane); }
    }
    h16* XN = (h16*)(ws + WS_XN);
    f32x4 gv[4];
#pragma unroll
    for (int j = 0; j < 4; ++j) gv[j] = *((const f32x4*)a.norm_g + lane + 64 * j);
    for (int m = gw; m < MTOK; m += NGW) {
        const f32x4* xr = (const f32x4*)(a.x + (size_t)m * DM) + lane;
        f32x4 v[4]; float s = 0.f;
#pragma unroll
        for (int j = 0; j < 4; ++j) { v[j] = xr[64 * j]; s += (v[j].x * v[j].x + v[j].y * v[j].y) + (v[j].z * v[j].z + v[j].w * v[j].w); }
        const float rstd = 1.f / sqrtf(wave_sum(s) * (1.f / DM) + NORM_EPS);
        u32x2* o8 = (u32x2*)(XN + (size_t)m * DM) + lane;
#pragma unroll
        for (int j = 0; j < 4; ++j) { const f32x4 y = v[j] * rstd * gv[j]; u32x2 w; w.x = pkh(y.x, y.y); w.y = pkh(y.z, y.w); o8[64 * j] = w; }
    }
    const int gt = blockIdx.x * 512 + tid, NGT = gridDim.x * 512;
    float* rope = (float*)(ws + WS_ROPE);
    for (int idx = gt; idx < SEQ * 8; idx += NGT) {
        const int pos = idx >> 3, i = idx & 7;
        double f = 1.0;
        switch (i) { case 1: f = 0.19392274474868576; break; case 2: f = 0.03760603093086393; break; case 3: f = 0.007292664737217109; break; case 4: f = 0.001414213562373095; break;
                     case 5: f = 0.0002742481756762073; break; case 6: f = 5.318295896944988e-05; break; case 7: f = 1.031338537721246e-05; break; default: break; }
        const double rev = (double)pos * f * 0.15915494309189535;
        const float fr_ = (float)(rev - __builtin_floor(rev));
        rope[pos * 16 + i] = __builtin_amdgcn_cosf(fr_); rope[pos * 16 + 8 + i] = __builtin_amdgcn_sinf(fr_);
    }
}

#define DPP_SHR(v, ident, d) __builtin_bit_cast(float, __builtin_amdgcn_update_dpp(__builtin_bit_cast(int, (float)(ident)), __builtin_bit_cast(int, (float)(v)), 0x110 + (d), 0xF, 0xF, false))

__device__ __forceinline__ void rnn_unit(const Args& a, LAS unsigned char* lds, int b, int n) {
    const int tid = threadIdx.x, lane = tid & 63, w = __builtin_amdgcn_readfirstlane(tid >> 6), fr = lane & 15, fq = lane >> 4;
    constexpr int UP = 272, TC = 64, NCH = SEQ / TC;
    unsigned char* ws = a.ws;
    const h16* U = (const h16*)(ws + WS_U); const h16* SGr = (const h16*)(ws + WS_SGR); h16* Y = (h16*)a.out;
    const h16* WA = (const h16*)(ws + WS_WG) + (size_t)n * 16384; const h16* WX = (const h16*)(ws + WS_WG) + (size_t)(8 + n) * 16384;
    h16x8 wa[4], wx[4];
#pragma unroll
    for (int kk = 0; kk < 4; ++kk) { wa[kk] = *(const h16x8*)(WA + (16 * w + fr) * 128 + 32 * kk + 8 * fq); wx[kk] = *(const h16x8*)(WX + (16 * w + fr) * 128 + 32 * kk + 8 * fq); }
    float ba[4], bx[4], ca[4], carry[4];
#pragma unroll
    for (int j = 0; j < 4; ++j) { const int ch = 128 * n + 16 * w + 4 * fq + j; ba[j] = a.lru_b_a[ch]; bx[j] = a.lru_b_x[ch];
        const float z = -a.lam[ch]; const float sp = fmaxf(z, 0.f) + log1pf(__expf(-fabsf(z))); ca[j] = -8.f * sp * LOG2E; carry[j] = 0.f; }
    const int cgp = tid & 31, tg = tid >> 5;
    f32x4 cw0, cw1, cw2, cw3, cbv;
    { const int ch = 128 * n + 4 * cgp; cw0 = *(const f32x4*)(a.conv_w + ch); cw1 = *(const f32x4*)(a.conv_w + 1024 + ch); cw2 = *(const f32x4*)(a.conv_w + 2048 + ch); cw3 = *(const f32x4*)(a.conv_w + 3072 + ch); cbv = *(const f32x4*)(a.conv_b + ch); }
    const h16* Ub = U + (size_t)b * SEQ * 1024 + 128 * n + 4 * cgp;
    u32x2 raw[7];
#define RNN_LOAD(c) do { _Pragma("unroll") for (int r = 0; r < 7; ++r) { const int t = (c) * TC + 4 * tg - 3 + r; raw[r] = (t >= 0) ? *(const u32x2*)(Ub + (size_t)t * 1024) : (u32x2){0u, 0u}; } } while (0)
#define RNN_CONV(buf) do { f32x4 xr[7]; _Pragma("unroll") for (int r = 0; r < 7; ++r) { const h16x4 hv = __builtin_bit_cast(h16x4, raw[r]); xr[r] = (f32x4){(float)hv[0], (float)hv[1], (float)hv[2], (float)hv[3]}; } \
        _Pragma("unroll") for (int q = 0; q < 4; ++q) { const f32x4 y = cbv + cw0 * xr[q] + cw1 * xr[q + 1] + cw2 * xr[q + 2] + cw3 * xr[q + 3]; u32x2 o; o.x = pkh(y[0], y[1]); o.y = pkh(y[2], y[3]); \
            *(LAS u32x2*)(lds + (buf) * (TC * UP) + (4 * tg + q) * UP + 8 * cgp) = o; } } while (0)
    RNN_LOAD(0); RNN_CONV(0);
    RNN_LOAD(1);
    __syncthreads();
    for (int c = 0; c < NCH; ++c) {
        if (c + 1 < NCH) { RNN_CONV((c + 1) & 1); if (c + 2 < NCH) RNN_LOAD(c + 2); }
        const LAS unsigned char* ubuf = lds + (c & 1) * (TC * UP);
        const size_t rowc = (size_t)b * SEQ + (size_t)c * TC;
        h16x4 sg[4];
#pragma unroll
        for (int nt = 0; nt < 4; ++nt) sg[nt] = *(const h16x4*)(SGr + (rowc + 16 * nt + fr) * 1024 + 128 * n + 16 * w + 4 * fq);
#pragma unroll
        for (int nt = 0; nt < 4; ++nt) {
            const LAS unsigned char* ub = ubuf + (16 * nt + fr) * UP;
            f32x4 aa = {0.f, 0.f, 0.f, 0.f}, ax = {0.f, 0.f, 0.f, 0.f};
#pragma unroll
            for (int kk = 0; kk < 4; ++kk) { const h16x8 bf = *(const LAS h16x8*)(ub + 64 * kk + 16 * fq);
                aa = __builtin_amdgcn_mfma_f32_16x16x32_f16(wa[kk], bf, aa, 0, 0, 0); ax = __builtin_amdgcn_mfma_f32_16x16x32_f16(wx[kk], bf, ax, 0, 0, 0); }
            const h16x4 uu = *(const LAS h16x4*)(ub + (16 * w + 4 * fq) * 2);
            float av[4], bv[4];
#pragma unroll
            for (int j = 0; j < 4; ++j) { const float r = sigm(aa[j] + ba[j]), ig = sigm(ax[j] + bx[j]);
                const float al = __builtin_amdgcn_exp2f(ca[j] * r); av[j] = al; bv[j] = __builtin_amdgcn_sqrtf(fmaxf(1.f - al * al, 0.f)) * (ig * (float)uu[j]); }
#define SCAN_STEP(d) do { _Pragma("unroll") for (int j = 0; j < 4; ++j) { const float ap = DPP_SHR(av[j], 1.0f, d), bp = DPP_SHR(bv[j], 0.0f, d); bv[j] = av[j] * bp + bv[j]; av[j] = av[j] * ap; } } while (0)
            SCAN_STEP(1); SCAN_STEP(2); SCAN_STEP(4); SCAN_STEP(8);
#undef SCAN_STEP
            float y[4];
#pragma unroll
            for (int j = 0; j < 4; ++j) { const float h = bv[j] + av[j] * carry[j]; carry[j] = __shfl(h, (lane & 48) | 15); y[j] = h * (float)sg[nt][j]; }
            u32x2 o; o.x = pkh(y[0], y[1]); o.y = pkh(y[2], y[3]);
            *(u32x2*)(Y + (rowc + 16 * nt + fr) * 2048 + 128 * n + 16 * w + 4 * fq) = o;
        }
        __syncthreads();
    }
#undef RNN_LOAD
#undef RNN_CONV
}

__device__ __forceinline__ void attn_unit(const Args& a, LAS unsigned char* lds, int b, int kh, int qc) {
    const int tid = threadIdx.x, lane = tid & 63, w = __builtin_amdgcn_readfirstlane(tid >> 6), fr = lane & 15, fq = lane >> 4;
    constexpr int KP = 144, VP = 544;
    unsigned char* ws = a.ws;
    const h16* Q = (const h16*)(ws + WS_Q); const h16* Kg = (const h16*)(ws + WS_K); const h16* Vg = (const h16*)(ws + WS_V); const h16* SGa = (const h16*)(ws + WS_SGA); h16* Y = (h16*)a.out;
    LAS unsigned char* Ks = lds; LAS unsigned char* Vt = lds + 256 * KP;
    const int t0 = qc * 128;
#pragma unroll
    for (int i = 0; i < 2; ++i) { const int id = tid + 512 * i, pr = id >> 3, ch = id & 7, row = 2 * pr, key = t0 - 128 + row;
        u32x4 k0 = {0u, 0u, 0u, 0u}, k1 = {0u, 0u, 0u, 0u}, v0 = {0u, 0u, 0u, 0u}, v1 = {0u, 0u, 0u, 0u};
        if (key >= 0) { const size_t g = ((size_t)b * SEQ + key) * 256 + kh * 64 + 8 * ch;
            k0 = *(const u32x4*)(Kg + g); k1 = *(const u32x4*)(Kg + g + 256); v0 = *(const u32x4*)(Vg + g); v1 = *(const u32x4*)(Vg + g + 256); }
        *(LAS u32x4*)(Ks + row * KP + ch * 16) = k0; *(LAS u32x4*)(Ks + (row + 1) * KP + ch * 16) = k1;
#pragma unroll
        for (int e2 = 0; e2 < 4; ++e2) { const unsigned a0 = v0[e2], a1 = v1[e2];
            *(LAS unsigned*)(Vt + (8 * ch + 2 * e2) * VP + row * 2) = (a0 & 0xffffu) | (a1 << 16);
            *(LAS unsigned*)(Vt + (8 * ch + 2 * e2 + 1) * VP + row * 2) = (a0 >> 16) | (a1 & 0xffff0000u); } }
    __syncthreads();
    const int hq = kh * 4 + (w >> 1), half = w & 1;
    const float sinkl2 = a.sinks[hq] * LOG2E;
    const float NEG = -INFINITY;
#pragma unroll 1
    for (int qt = 0; qt < 4; ++qt) {
        const int q0 = 64 * half + 16 * qt;
        const size_t qrow = (size_t)b * SEQ + t0 + q0 + fr;
        h16x8 qf[2];
#pragma unroll
        for (int kd = 0; kd < 2; ++kd) qf[kd] = *(const h16x8*)(Q + qrow * 1024 + hq * 64 + 32 * kd + 8 * fq);
        f32x4 s[9];
#pragma unroll
        for (int kt = 0; kt < 9; ++kt) { f32x4 acc = {0.f, 0.f, 0.f, 0.f};
#pragma unroll
            for (int kd = 0; kd < 2; ++kd) { const h16x8 af = *(const LAS h16x8*)(Ks + (q0 + 16 * kt + fr) * KP + 64 * kd + 16 * fq); acc = __builtin_amdgcn_mfma_f32_16x16x32_f16(af, qf[kd], acc, 0, 0, 0); }
            s[kt] = acc; }
#pragma unroll
        for (int jj = 0; jj < 4; ++jj) { const int kl = 4 * fq + jj; if (!(kl > fr)) s[0][jj] = NEG; if (!(kl <= fr)) s[8][jj] = NEG; }
        if (t0 == 0) {
#pragma unroll
            for (int kt = 0; kt < 9; ++kt) if (q0 + 16 * kt < 128) s[kt] = (f32x4){NEG, NEG, NEG, NEG};
        }
        float mx = sinkl2;
#pragma unroll
        for (int kt = 0; kt < 9; ++kt) mx = fmaxf(fmaxf(mx, fmaxf(s[kt][0], s[kt][1])), fmaxf(s[kt][2], s[kt][3]));
        mx = fmaxf(mx, __shfl_xor(mx, 16)); mx = fmaxf(mx, __shfl_xor(mx, 32));
        float l = 0.f;
#pragma unroll
        for (int kt = 0; kt < 9; ++kt)
#pragma unroll
            for (int jj = 0; jj < 4; ++jj) { const float p = __builtin_amdgcn_exp2f(s[kt][jj] - mx); s[kt][jj] = p; l += p; }
        l += __shfl_xor(l, 16); l += __shfl_xor(l, 32);
        l += __builtin_amdgcn_exp2f(sinkl2 - mx);
        const float rl = __builtin_amdgcn_rcpf(l);
        h16x8 pf[4]; h16x4 pl;
#pragma unroll
        for (int ks = 0; ks < 4; ++ks) pf[ks] = (h16x8){(h16)s[2 * ks][0], (h16)s[2 * ks][1], (h16)s[2 * ks][2], (h16)s[2 * ks][3], (h16)s[2 * ks + 1][0], (h16)s[2 * ks + 1][1], (h16)s[2 * ks + 1][2], (h16)s[2 * ks + 1][3]};
        pl = (h16x4){(h16)s[8][0], (h16)s[8][1], (h16)s[8][2], (h16)s[8][3]};
#if DBG_ATT == 4
#pragma unroll
        for (int ks = 0; ks < 4; ++ks) pf[ks] = (h16x8){(h16)1.f, (h16)1.f, (h16)1.f, (h16)1.f, (h16)1.f, (h16)1.f, (h16)1.f, (h16)1.f};
        pl = (h16x4){(h16)1.f, (h16)1.f, (h16)1.f, (h16)1.f};
#endif
        const LAS unsigned char* vb = Vt + fr * VP + (q0 + 4 * fq) * 2;
        f32x4 oacc[4];
#pragma unroll
        for (int dt = 0; dt < 4; ++dt) oacc[dt] = (f32x4){0.f, 0.f, 0.f, 0.f};
#pragma unroll
        for (int ks = 0; ks < 4; ++ks) {
#pragma unroll
            for (int dt = 0; dt < 4; ++dt) { const h16x4 lo = *(const LAS h16x4*)(vb + dt * 16 * VP + 64 * ks), hi = *(const LAS h16x4*)(vb + dt * 16 * VP + 64 * ks + 32);
                h16x8 vf = __builtin_shufflevector(lo, hi, 0, 1, 2, 3, 4, 5, 6, 7);
                oacc[dt] = __builtin_amdgcn_mfma_f32_16x16x32_f16(vf, pf[ks], oacc[dt], 0, 0, 0); }
        }
        { const h16x4 z4 = {(h16)0.f, (h16)0.f, (h16)0.f, (h16)0.f};
          const h16x8 plz = __builtin_shufflevector(pl, z4, 0, 1, 2, 3, 4, 5, 6, 7);
#pragma unroll
          for (int dt = 0; dt < 4; ++dt) { const h16x4 lv = *(const LAS h16x4*)(vb + dt * 16 * VP + 256);
              const h16x8 vf = __builtin_shufflevector(lv, z4, 0, 1, 2, 3, 4, 5, 6, 7);
              oacc[dt] = __builtin_amdgcn_mfma_f32_16x16x32_f16(vf, plz, oacc[dt], 0, 0, 0); } }
#pragma unroll
        for (int dt = 0; dt < 4; ++dt) {
            const int col = hq * 64 + 16 * dt + 4 * fq;
            const h16x4 sg = *(const h16x4*)(SGa + qrow * 1024 + col);
            u32x2 o; o.x = pkh(oacc[dt][0] * rl * (float)sg[0], oacc[dt][1] * rl * (float)sg[1]); o.y = pkh(oacc[dt][2] * rl * (float)sg[2], oacc[dt][3] * rl * (float)sg[3]);
#if DBG_ATT >= 2
            o.x = pkh(oacc[dt][0], oacc[dt][1]); o.y = pkh(oacc[dt][2], oacc[dt][3]);
#endif
            *(u32x2*)(Y + qrow * 2048 + 1024 + col) = o;
        }
    }
    __syncthreads();
}


#ifndef DBG_SKIPROWS
#define DBG_SKIPROWS 0
#endif
#ifndef DBG_OUT
#define DBG_OUT 0
#endif
__device__ __forceinline__ void dbg_dump(const Args& a, int k, cg::grid_group& grid) {
    unsigned char* ws = a.ws;
    const size_t gt = (size_t)blockIdx.x * 512 + threadIdx.x, NGT = (size_t)gridDim.x * 512;
    const size_t NE = (size_t)MTOK * DM;
    if (k == 1) {
        const h16 *U = (const h16*)(ws + WS_U), *SGr = (const h16*)(ws + WS_SGR), *Q = (const h16*)(ws + WS_Q), *SGa = (const h16*)(ws + WS_SGA), *SR = (const h16*)(ws + WS_SR), *SA = (const h16*)(ws + WS_SA);
        const h16 *Kb = (const h16*)(ws + WS_K), *Vb = (const h16*)(ws + WS_V);
        for (size_t i = gt; i < NE; i += NGT) { const size_t row = i >> 10, c = i & 1023;
            float v = (float)U[i] + (float)SGr[i] + (float)Q[i] + (float)SGa[i] + (float)SR[i] + (float)SA[i];
            if (c < 256) v += (float)Kb[row * 256 + c] + (float)Vb[row * 256 + c];
            a.out[i] = v; }
    } else if (k == 2 || k == 5 || k == 6) {
        const h16* Y = (const h16*)a.out; float* tmp = (float*)(ws + WS_U);
        for (size_t i = gt; i < NE; i += NGT) { const size_t row = i >> 10, c = i & 1023; tmp[i] = (k != 6 ? (float)Y[row * 2048 + c] : 0.f) + (k != 5 ? 3.f * (float)Y[row * 2048 + 1024 + c] : 0.f); if ((row & 2047) < DBG_SKIPROWS) tmp[i] = 0.f; }
        grid.sync();
        for (size_t i = gt; i < NE; i += NGT) a.out[i] = tmp[i];
    } else if (k == 3) {
        const h16* MG = (const h16*)(ws + WS_XN);
        for (size_t i = gt; i < NE; i += NGT) a.out[i] = (float)MG[i];
    }
}
constexpr int LDS_BYTES = 147456;
constexpr int QOFF = 131072 + 1024;

__global__ void __launch_bounds__(512, 2) fwd_megakernel(Args a) {
    extern __shared__ __attribute__((aligned(16))) unsigned char lds_raw[];
    LAS unsigned char* lds = (LAS unsigned char*)lds_raw;
    cg::grid_group grid = cg::this_grid();
    unsigned char* ws = a.ws;
    const int lo = a.ph_lo, hi = a.ph_hi;
#ifndef PHASE_MASK
#define PHASE_MASK 63
#endif
#define IN(k) (((PHASE_MASK >> (k)) & 1) && lo <= (k) && (k) < hi)
#define SEAM(k) do { if (IN(k) && IN((k) + 1)) grid.sync(); } while (0)
    const int G = gridDim.x;

    if (IN(0)) { p0_prologue(a, lds); SEAM(0); }

    if (IN(1)) {
        pg8::Gemm g{(const h16*)(ws + WS_XN), (const h16*)(ws + WS_WIN), MTOK, NIN, 1024}; pg8::StaticOrder S; S.init(MTOK, NIN, G, (int)blockIdx.x);
        EpiProj E{(h16*)(ws + WS_U), (h16*)(ws + WS_SGR), (h16*)(ws + WS_Q), (h16*)(ws + WS_K), (h16*)(ws + WS_V), (h16*)(ws + WS_SGA), (h16*)(ws + WS_SR), (h16*)(ws + WS_SA), (const float*)(ws + WS_ROPE)};
        pg8::gemm_phase<EpiProj>(lds, g, S, E);
        SEAM(1);
    }
    if (DBG_OUT == 1) { dbg_dump(a, 1, grid); return; }

    if (IN(2)) {
        unsigned* ctr = (unsigned*)(ws + WS_CTL);
        LAS int* sq = (LAS int*)(lds + QOFF);
        for (;;) {
            if (threadIdx.x == 0) *sq = (int)atomicAdd(ctr, 1u);
            __syncthreads();
            const int u = __builtin_amdgcn_readfirstlane(*sq);
            __syncthreads();
            if (u >= N_RNN_UNITS + N_ATT_UNITS) break;
            if (u < N_RNN_UNITS) rnn_unit(a, lds, u >> 3, u & 7);
            else { const int au = u - N_RNN_UNITS; attn_unit(a, lds, au >> 6, (au >> 4) & 3, au & 15); }
        }
        SEAM(2);
    }
    if (DBG_OUT == 2 || DBG_OUT == 5 || DBG_OUT == 6) { dbg_dump(a, DBG_OUT, grid); return; }

    if (IN(3)) {
        pg8::Gemm g{(const h16*)a.out, (const h16*)(ws + WS_WCAT), MTOK, 1024, 2048}; pg8::StaticOrder S; S.init(MTOK, 1024, G, (int)blockIdx.x);
        EpiMerge E{(const h16*)(ws + WS_SR), (const h16*)(ws + WS_SA), (h16*)(ws + WS_XN)};
        pg8::gemm_phase<EpiMerge>(lds, g, S, E);
        SEAM(3);
    }
    if (DBG_OUT == 3) { dbg_dump(a, 3, grid); return; }

    if (IN(4)) {
        pg8::Gemm g{(const h16*)(ws + WS_XN), (const h16*)(ws + WS_WO), MTOK, 1024, 1024}; pg8::StaticOrder S; S.init(MTOK, 1024, G, (int)blockIdx.x);
        EpiOut E{a.x, a.out, (float*)(ws + WS_RSS)};
        pg8::gemm_phase<EpiOut>(lds, g, S, E);
        SEAM(4);
    }
    if (DBG_OUT == 4) return;

    if (IN(5)) {
        const int tid = threadIdx.x, lane = tid & 63, wave = tid >> 6;
        const int gw = blockIdx.x * 8 + wave, NGW = G * 8;
        const float* rss = (const float*)(ws + WS_RSS);
        f32x4 gv[4];
#pragma unroll
        for (int j = 0; j < 4; ++j) gv[j] = *((const f32x4*)a.fng + lane + 64 * j);
        for (int m = gw; m < MTOK; m += NGW) {
            const f32x4* pp = (const f32x4*)(rss + (size_t)m * 16);
            const f32x4 p0 = pp[0], p1 = pp[1], p2 = pp[2], p3 = pp[3];
            const float ssum = ((p0[0] + p0[1]) + (p0[2] + p0[3])) + ((p1[0] + p1[1]) + (p1[2] + p1[3])) + ((p2[0] + p2[1]) + (p2[2] + p2[3])) + ((p3[0] + p3[1]) + (p3[2] + p3[3]));
            const float rstd = 1.f / sqrtf(ssum * (1.f / DM) + NORM_EPS);
            f32x4* xr = (f32x4*)(a.out + (size_t)m * DM) + lane;
#pragma unroll
            for (int j = 0; j < 4; ++j) xr[64 * j] = xr[64 * j] * rstd * gv[j];
        }
    }
#undef IN
#undef SEAM
}

extern "C" void kernel_launch(void* const* d_in, const int* in_sizes, int n_in, void* d_out, int out_size, void* d_ws, size_t ws_size, hipStream_t stream) {
    static int grid = 0;
    if (grid == 0) {
        if (n_in != 15 || in_sizes[0] != MTOK * DM || out_size != MTOK * DM || ws_size < WS_END) {
            fprintf(stderr, "kernel_launch: unexpected shapes (n_in %d, in0 %d, out %d, ws %zu); nothing launched\n", n_in, n_in > 0 ? in_sizes[0] : -1, out_size, ws_size); grid = -1; return; }
        int dev = 0, cus = 0, per_cu = 0;
        if (hipGetDevice(&dev) != hipSuccess || hipDeviceGetAttribute(&cus, hipDeviceAttributeMultiprocessorCount, dev) != hipSuccess) { grid = -1; return; }
        if (hipFuncSetAttribute((const void*)fwd_megakernel, hipFuncAttributeMaxDynamicSharedMemorySize, LDS_BYTES) != hipSuccess) { fprintf(stderr, "kernel_launch: hipFuncSetAttribute failed\n"); grid = -1; return; }
        if (hipOccupancyMaxActiveBlocksPerMultiprocessor(&per_cu, (const void*)fwd_megakernel, 512, LDS_BYTES) != hipSuccess || per_cu < 1) { fprintf(stderr, "kernel_launch: occupancy query says %d\n", per_cu); per_cu = 1; }
        (void)hipGetLastError();
        grid = cus * 1;
    }
    if (grid < 0) return;
    (void)hipMemsetAsync((char*)d_ws + WS_CTL, 0, CTL_ZERO_BYTES, stream);
    Args a{};
    a.x = (const float*)d_in[0]; a.norm_g = (const float*)d_in[1]; a.w_in = (const float*)d_in[2]; a.conv_w = (const float*)d_in[3]; a.conv_b = (const float*)d_in[4];
    a.lru_w_a = (const float*)d_in[5]; a.lru_b_a = (const float*)d_in[6]; a.lru_w_x = (const float*)d_in[7]; a.lru_b_x = (const float*)d_in[8]; a.lam = (const float*)d_in[9];
    a.sinks = (const float*)d_in[10]; a.w_rnn_out = (const float*)d_in[11]; a.w_attn_out = (const float*)d_in[12]; a.w_o = (const float*)d_in[13]; a.fng = (const float*)d_in[14];
    a.out = (float*)d_out; a.ws = (unsigned char*)d_ws;
#if MK_N_LAUNCHES == 1
    a.ph_lo = 0; a.ph_hi = 6;
    void* args[] = {&a};
    hipError_t e = hipLaunchCooperativeKernel((const void*)fwd_megakernel, dim3(grid), dim3(512), args, LDS_BYTES, stream);
    if (e != hipSuccess) fprintf(stderr, "cooperative launch failed: %s (grid %d)\n", hipGetErrorString(e), grid);
#else
    for (int p = 0; p < 6; ++p) { a.ph_lo = p; a.ph_hi = p + 1; hipLaunchKernelGGL(fwd_megakernel, dim3(grid), dim3(512), LDS_BYTES, stream, a); }
#endif
}
```
